# Optimizing an MI355X kernel written in HIP

```python
import jax, jax.numpy as jnp
from jax import lax
import numpy as np

D_MODEL = 1024
BATCH = 2
SEQ = 8192
DEPTH = 2
DEC_BATCH = 128
DEC_SEQ = 4
PAST_LEN = 16384
PAGE_SIZE = 128

N_HEADS = 8
HEAD_DIM = 64
N_KV_HEADS = 2
GROUP = N_HEADS // N_KV_HEADS
ATTN_WIDTH = N_HEADS * HEAD_DIM
KV_WIDTH = N_KV_HEADS * HEAD_DIM
WINDOW = 128
ROPE_THETA = 500000.0
ROT_DIM = HEAD_DIM // 4
LRU_WIDTH = D_MODEL // 2
LRU_HEADS = 8
LRU_BLOCK = LRU_WIDTH // LRU_HEADS
CONV_W = 4
LRU_C = 8.0
D_FF = 2816
MIX_WIDTH = ATTN_WIDTH + LRU_WIDTH
IN_WIDTH = ATTN_WIDTH + 2 * KV_WIDTH + 2 * LRU_WIDTH
EPS = 1e-6

kernel_name = 'hymba_swa_sink_rglru_macaron_step'


def rmsnorm(x, g):
    xf = x.astype(jnp.float32)
    y = xf * lax.rsqrt(jnp.mean(xf * xf, axis=-1, keepdims=True) + EPS)
    return (y * g.astype(jnp.float32)).astype(x.dtype)


def rope(x, pos):
    half = ROT_DIM // 2
    inv = ROPE_THETA ** (-(jnp.arange(half, dtype=jnp.float32) * 2.0) / ROT_DIM)
    ang = pos.astype(jnp.float32)[:, None] * inv[None, :]
    cos = jnp.cos(ang)[:, None, :]
    sin = jnp.sin(ang)[:, None, :]
    xr = x[..., :ROT_DIM].astype(jnp.float32)
    x1, x2 = xr[..., :half], xr[..., half:]
    rot = jnp.concatenate([x1 * cos - x2 * sin, x2 * cos + x1 * sin], axis=-1).astype(x.dtype)
    return jnp.concatenate([rot, x[..., ROT_DIM:]], axis=-1)


def sink_attention(q, k, v, mask, sinks):
    lead = q.shape[:-3]
    tq = q.shape[-3]
    qg = q.reshape(*lead, tq, N_KV_HEADS, GROUP, HEAD_DIM)
    s = jnp.einsum('...qkgd,...skd->...kgqs', qg, k).astype(jnp.float32) * (HEAD_DIM ** -0.5)
    s = jnp.where(mask, s, -jnp.inf)
    sink = sinks.astype(jnp.float32).reshape(N_KV_HEADS, GROUP)[:, :, None, None]
    m = jnp.maximum(jnp.max(s, axis=-1, keepdims=True), sink)
    p = jnp.exp(s - m)
    p = p / (jnp.sum(p, axis=-1, keepdims=True) + jnp.exp(sink - m))
    o = jnp.einsum('...kgqs,...skd->...qkgd', p.astype(v.dtype), v)
    return o.reshape(*lead, tq, ATTN_WIDTH)


def attn_prompt(q, k, v, sinks):
    b, s = q.shape[:2]
    nb = s // WINDOW
    qb = q.reshape(b, nb, WINDOW, N_HEADS, HEAD_DIM)
    kb = k.reshape(b, nb, WINDOW, N_KV_HEADS, HEAD_DIM)
    vb = v.reshape(b, nb, WINDOW, N_KV_HEADS, HEAD_DIM)
    pad = ((0, 0), (1, 0), (0, 0), (0, 0), (0, 0))
    kcat = jnp.concatenate([jnp.pad(kb, pad)[:, :-1], kb], axis=2)
    vcat = jnp.concatenate([jnp.pad(vb, pad)[:, :-1], vb], axis=2)
    qi = jnp.arange(WINDOW)
    kj = jnp.arange(2 * WINDOW)
    diff = qi[:, None] + WINDOW - kj[None, :]
    band = (diff >= 0) & (diff < WINDOW)
    has_prev = (jnp.arange(nb)[:, None, None] > 0) | (kj[None, None, :] >= WINDOW)
    mask = (band[None] & has_prev)[:, None, None]
    out = sink_attention(qb, kcat, vcat, mask, sinks)
    wb = min(WINDOW, s)
    return out.reshape(b, s, ATTN_WIDTH), k[:, s - wb:], v[:, s - wb:]


def attn_sample(q, k, v, sinks, k_buf, v_buf):
    tb = k_buf.shape[1]
    t = q.shape[1]
    kcat = jnp.concatenate([k_buf, k], axis=1)
    vcat = jnp.concatenate([v_buf, v], axis=1)
    q_pos = PAST_LEN + jnp.arange(t)
    k_pos = PAST_LEN - tb + jnp.arange(tb + t)
    diff = q_pos[:, None] - k_pos[None, :]
    mask = (diff >= 0) & (diff < WINDOW)
    out = sink_attention(q, kcat, vcat, mask, sinks)
    return out, kcat[:, t:], vcat[:, t:]


def causal_conv(xp, w, bias):
    t = xp.shape[1] - (CONV_W - 1)
    out = bias + xp[:, 0:t] * w[0]
    for j in range(1, CONV_W):
        out = out + xp[:, j:j + t] * w[j]
    return out


def rglru(xc, h0, wa, ba, wx, bx, lam):
    b, t, _ = xc.shape
    xb = xc.reshape(b, t, LRU_HEADS, LRU_BLOCK)
    r = jax.nn.sigmoid(jnp.einsum('bthi,hij->bthj', xb, wa).reshape(b, t, LRU_WIDTH) + ba)
    ig = jax.nn.sigmoid(jnp.einsum('bthi,hij->bthj', xb, wx).reshape(b, t, LRU_WIDTH) + bx)
    log_a = -LRU_C * r.astype(jnp.float32) * jax.nn.softplus(-lam.astype(jnp.float32))
    a = jnp.exp(log_a)
    u = jnp.sqrt(-jnp.expm1(2.0 * log_a)) * (ig * xc).astype(jnp.float32)

    def step(h, au):
        a_t, u_t = au
        h = a_t * h + u_t
        return h, h

    h_last, hs = lax.scan(step, h0.astype(jnp.float32), (jnp.swapaxes(a, 0, 1), jnp.swapaxes(u, 0, 1)))
    return jnp.swapaxes(hs, 0, 1).astype(xc.dtype), h_last.astype(h0.dtype)


def swiglu(x, wg, wu, wd):
    return (jax.nn.silu(x @ wg) * (x @ wu)) @ wd


def half_ffn(x, g_pre, wg, wu, wd, g_post):
    return x + 0.5 * rmsnorm(swiglu(rmsnorm(x, g_pre), wg, wu, wd), g_post)


def token_mixer(x, p, l, pos, attend, conv_prefix, h0):
    b, t = x.shape[:2]
    h = rmsnorm(x, p['norm_pre_mix'][l])
    z = h @ p['w_in'][l]
    o1 = ATTN_WIDTH
    o2 = o1 + KV_WIDTH
    o3 = o2 + KV_WIDTH
    o4 = o3 + LRU_WIDTH
    q = rope(z[..., :o1].reshape(b, t, N_HEADS, HEAD_DIM), pos)
    k = rope(z[..., o1:o2].reshape(b, t, N_KV_HEADS, HEAD_DIM), pos)
    v = z[..., o2:o3].reshape(b, t, N_KV_HEADS, HEAD_DIM)
    xr = z[..., o3:o4]
    yg = z[..., o4:]
    attn, new_k, new_v = attend(q, k, v, p['sinks'][l])
    xp = jnp.concatenate([conv_prefix, xr], axis=1)
    xc = causal_conv(xp, p['conv_w'][l], p['conv_b'][l])
    new_conv = xp[:, xp.shape[1] - (CONV_W - 1):]
    lru, h_last = rglru(xc, h0, p['gate_a_w'][l], p['gate_a_b'][l], p['gate_x_w'][l], p['gate_x_b'][l], p['lru_lambda'][l])
    lru = lru * jax.nn.gelu(yg)
    mixed = jnp.concatenate([rmsnorm(attn, p['attn_out_norm'][l]), rmsnorm(lru, p['lru_out_norm'][l])], axis=-1)
    x = x + rmsnorm(mixed @ p['w_o'][l], p['norm_post_mix'][l])
    return x, new_k, new_v, new_conv, h_last


def layer(x, p, l, pos, attend, conv_prefix, h0):
    x = half_ffn(x, p['norm_pre_ffn1'][l], p['ffn1_w_gate'][l], p['ffn1_w_up'][l], p['ffn1_w_down'][l], p['norm_post_ffn1'][l])
    x, nk, nv, nc, nh = token_mixer(x, p, l, pos, attend, conv_prefix, h0)
    x = half_ffn(x, p['norm_pre_ffn2'][l], p['ffn2_w_gate'][l], p['ffn2_w_up'][l], p['ffn2_w_down'][l], p['norm_post_ffn2'][l])
    return x, nk, nv, nc, nh


def setup_inputs(seed: int = 0) -> dict:
    key = jax.random.key(seed)
    ks = iter(jax.random.split(key, 40))
    f32 = jnp.float32
    wb = min(WINDOW, PAST_LEN)

    def nrm(shape, scale):
        return jax.random.normal(next(ks), shape, f32) * scale

    def gain(shape):
        return 1.0 + 0.02 * jax.random.normal(next(ks), shape, f32)

    u = jax.random.uniform(next(ks), (DEPTH, LRU_WIDTH), f32, 0.9, 0.999)
    lam = jnp.log(u) - jnp.log1p(-u)
    return {
        'x_prompt': nrm((BATCH, SEQ, D_MODEL), 1.0),
        'x_sample': nrm((DEC_BATCH, DEC_SEQ, D_MODEL), 1.0),
        'cache_k': nrm((DEPTH, DEC_BATCH, wb, N_KV_HEADS, HEAD_DIM), 1.0),
        'cache_v': nrm((DEPTH, DEC_BATCH, wb, N_KV_HEADS, HEAD_DIM), 1.0),
        'state_conv': nrm((DEPTH, DEC_BATCH, CONV_W - 1, LRU_WIDTH), 1.0),
        'state_h': nrm((DEPTH, DEC_BATCH, LRU_WIDTH), 0.5),
        'norm_pre_ffn1': gain((DEPTH, D_MODEL)),
        'ffn1_w_gate': nrm((DEPTH, D_MODEL, D_FF), D_MODEL ** -0.5),
        'ffn1_w_up': nrm((DEPTH, D_MODEL, D_FF), D_MODEL ** -0.5),
        'ffn1_w_down': nrm((DEPTH, D_FF, D_MODEL), D_FF ** -0.5),
        'norm_post_ffn1': gain((DEPTH, D_MODEL)),
        'norm_pre_mix': gain((DEPTH, D_MODEL)),
        'w_in': nrm((DEPTH, D_MODEL, IN_WIDTH), D_MODEL ** -0.5),
        'sinks': nrm((DEPTH, N_HEADS), 0.5),
        'conv_w': nrm((DEPTH, CONV_W, LRU_WIDTH), CONV_W ** -0.5),
        'conv_b': nrm((DEPTH, LRU_WIDTH), 0.01),
        'gate_a_w': nrm((DEPTH, LRU_HEADS, LRU_BLOCK, LRU_BLOCK), LRU_BLOCK ** -0.5),
        'gate_a_b': nrm((DEPTH, LRU_WIDTH), 0.01),
        'gate_x_w': nrm((DEPTH, LRU_HEADS, LRU_BLOCK, LRU_BLOCK), LRU_BLOCK ** -0.5),
        'gate_x_b': nrm((DEPTH, LRU_WIDTH), 0.01),
        'lru_lambda': lam,
        'attn_out_norm': gain((DEPTH, ATTN_WIDTH)),
        'lru_out_norm': gain((DEPTH, LRU_WIDTH)),
        'w_o': nrm((DEPTH, MIX_WIDTH, D_MODEL), MIX_WIDTH ** -0.5),
        'norm_post_mix': gain((DEPTH, D_MODEL)),
        'norm_pre_ffn2': gain((DEPTH, D_MODEL)),
        'ffn2_w_gate': nrm((DEPTH, D_MODEL, D_FF), D_MODEL ** -0.5),
        'ffn2_w_up': nrm((DEPTH, D_MODEL, D_FF), D_MODEL ** -0.5),
        'ffn2_w_down': nrm((DEPTH, D_FF, D_MODEL), D_FF ** -0.5),
        'norm_post_ffn2': gain((DEPTH, D_MODEL)),
    }


def reference(x_prompt, x_sample, cache_k, cache_v, state_conv, state_h,
              norm_pre_ffn1, ffn1_w_gate, ffn1_w_up, ffn1_w_down, norm_post_ffn1,
              norm_pre_mix, w_in, sinks, conv_w, conv_b, gate_a_w, gate_a_b, gate_x_w, gate_x_b,
              lru_lambda, attn_out_norm, lru_out_norm, w_o, norm_post_mix,
              norm_pre_ffn2, ffn2_w_gate, ffn2_w_up, ffn2_w_down, norm_post_ffn2):
    p = dict(norm_pre_ffn1=norm_pre_ffn1, ffn1_w_gate=ffn1_w_gate, ffn1_w_up=ffn1_w_up,
             ffn1_w_down=ffn1_w_down, norm_post_ffn1=norm_post_ffn1, norm_pre_mix=norm_pre_mix,
             w_in=w_in, sinks=sinks, conv_w=conv_w, conv_b=conv_b, gate_a_w=gate_a_w,
             gate_a_b=gate_a_b, gate_x_w=gate_x_w, gate_x_b=gate_x_b, lru_lambda=lru_lambda,
             attn_out_norm=attn_out_norm, lru_out_norm=lru_out_norm, w_o=w_o,
             norm_post_mix=norm_post_mix, norm_pre_ffn2=norm_pre_ffn2, ffn2_w_gate=ffn2_w_gate,
             ffn2_w_up=ffn2_w_up, ffn2_w_down=ffn2_w_down, norm_post_ffn2=norm_post_ffn2)
    b, s = x_prompt.shape[:2]
    db, t = x_sample.shape[:2]
    pos_p = jnp.arange(s)
    pos_s = PAST_LEN + jnp.arange(t)
    xp, xs = x_prompt, x_sample
    kp, vp, cp, hp = [], [], [], []
    ksm, vsm, csm, hsm = [], [], [], []
    for l in range(DEPTH):
        conv0 = jnp.zeros((b, CONV_W - 1, LRU_WIDTH), x_prompt.dtype)
        h0 = jnp.zeros((b, LRU_WIDTH), state_h.dtype)
        xp, nk, nv, nc, nh = layer(xp, p, l, pos_p, attn_prompt, conv0, h0)
        kp.append(nk); vp.append(nv); cp.append(nc); hp.append(nh)
        kb, vb = cache_k[l], cache_v[l]
        attend_s = lambda q, k, v, snk, kb=kb, vb=vb: attn_sample(q, k, v, snk, kb, vb)
        xs, nk, nv, nc, nh = layer(xs, p, l, pos_s, attend_s, state_conv[l], state_h[l])
        ksm.append(nk); vsm.append(nv); csm.append(nc); hsm.append(nh)
    return (xp, xs,
            jnp.stack(kp), jnp.stack(vp), jnp.stack(cp), jnp.stack(hp),
            jnp.stack(ksm), jnp.stack(vsm), jnp.stack(csm), jnp.stack(hsm))
```

```cpp
#include <hip/hip_runtime.h>
#include <hip/hip_cooperative_groups.h>
#include <cstdio>
#include <cstdint>
namespace cg = cooperative_groups;

#define LAS __attribute__((address_space(3)))
typedef unsigned short bf16_t;
typedef short bf16x8 __attribute__((ext_vector_type(8)));
typedef short s16x4 __attribute__((ext_vector_type(4)));
typedef float f32x4 __attribute__((ext_vector_type(4)));
typedef float f32x16 __attribute__((ext_vector_type(16)));
typedef unsigned u32x4 __attribute__((ext_vector_type(4)));
typedef unsigned u32x2 __attribute__((ext_vector_type(2)));

constexpr int DM = 1024, SEQ = 8192, NB = 2, MP = NB * SEQ, DB = 128, DT = 4, MS = DB * DT, M = MP + MS;
constexpr int DFF = 2816, NIN = 1792, AW = 512, LW = 512, PAST = 16384;
constexpr int XR_OFF = 768, YG_OFF = 1280, K_OFF = 512, V_OFF = 640;
constexpr float EPS = 1e-6f;
constexpr int CH = 64, NCH = SEQ / CH;

constexpr size_t MiB = 1u << 20;
constexpr size_t WS_CTL = 0, CTL_BYTES = 64 * 1024;
constexpr size_t WS_W = 1 * MiB;
constexpr size_t W_GU = (size_t)2 * DFF * DM * 2, W_D = (size_t)DM * DFF * 2, W_IN = (size_t)NIN * DM * 2, W_O = (size_t)DM * DM * 2, W_G = 65536;
constexpr size_t OFF_GU1 = 0, OFF_D1 = OFF_GU1 + W_GU, OFF_IN = OFF_D1 + W_D, OFF_O = OFF_IN + W_IN, OFF_GU2 = OFF_O + W_O, OFF_D2 = OFF_GU2 + W_GU,
                 OFF_GA = OFF_D2 + W_D, OFF_GX = OFF_GA + W_G, LAYER_W = OFF_GX + W_G;
constexpr size_t WS_XN = 79 * MiB, WS_Y = 112 * MiB, WS_H = 145 * MiB, WS_SUM = 236 * MiB, WS_END = 238 * MiB;
static_assert(WS_W + 2 * LAYER_W <= WS_XN, "weights fit");
static_assert(WS_H + (size_t)M * DFF * 2 <= WS_SUM, "H fits");
constexpr size_t WS_Z = WS_H, WS_MIX = WS_H + (size_t)M * NIN * 2;
static_assert(WS_MIX + (size_t)M * DM * 2 <= WS_SUM, "Z+MIX fit");
constexpr size_t WS_ATTO = WS_XN;
constexpr size_t WS_HL = WS_Y, WS_PP = WS_Y + (size_t)M * LW * 2;
static_assert(WS_PP + (size_t)M * LW * 2 <= WS_H, "HL/PP fit in Y");

constexpr size_t O_KP = (size_t)M * DM, O_VP = O_KP + 65536, O_CP = O_VP + 65536, O_HP = O_CP + 6144, O_KS = O_HP + 2048,
                 O_VS = O_KS + 4194304, O_CS = O_VS + 4194304, O_HS = O_CS + 393216;

constexpr int LDS_BYTES = 147456;

__device__ __forceinline__ unsigned pk2(float lo, float hi) {
    typedef float f2 __attribute__((ext_vector_type(2))); typedef __bf16 b2 __attribute__((ext_vector_type(2)));
    f2 v = {lo, hi}; b2 b = __builtin_convertvector(v, b2); return __builtin_bit_cast(unsigned, b);
}
__device__ __forceinline__ float bflo(unsigned w) { return __uint_as_float(w << 16); }
__device__ __forceinline__ float bfhi(unsigned w) { return __uint_as_float(w & 0xffff0000u); }
__device__ __forceinline__ float bf2f(unsigned short h) { return __uint_as_float((unsigned)h << 16); }
__device__ __forceinline__ float wave_sum(float v) {
#pragma unroll
    for (int o = 1; o < 64; o <<= 1) v += __shfl_xor(v, o);
    return v;
}
__device__ __forceinline__ void unpack8(const u32x4& w, float* f) {
    f[0] = bflo(w.x); f[1] = bfhi(w.x); f[2] = bflo(w.y); f[3] = bfhi(w.y); f[4] = bflo(w.z); f[5] = bfhi(w.z); f[6] = bflo(w.w); f[7] = bfhi(w.w);
}
__device__ __forceinline__ u32x4 pack8(const float* f) { u32x4 w; w.x = pk2(f[0], f[1]); w.y = pk2(f[2], f[3]); w.z = pk2(f[4], f[5]); w.w = pk2(f[6], f[7]); return w; }
__device__ __forceinline__ void sincos_pos(float pos, int e, float& s, float& c) {
    const float inv = exp2f(-(float)e * 2.3664460711f);
    const float ang = pos * inv; float r = ang * 0.15915494309189535f; r = r - floorf(r);
    s = __builtin_amdgcn_sinf(r); c = __builtin_amdgcn_cosf(r);
}
__device__ __forceinline__ void rope8(u32x4& a, u32x4& b, float pos) {
    float x1[8], x2[8]; unpack8(a, x1); unpack8(b, x2);
#pragma unroll
    for (int e = 0; e < 8; ++e) { float s, c; sincos_pos(pos, e, s, c); const float r1 = x1[e] * c - x2[e] * s, r2 = x2[e] * c + x1[e] * s; x1[e] = r1; x2[e] = r2; }
    a = pack8(x1); b = pack8(x2);
}
__device__ __forceinline__ float sigmoidf_(float x) { return 1.0f / (1.0f + __expf(-x)); }
__device__ __forceinline__ float gelu_tanh(float x) { const float y = 0.7978845608028654f * (x + 0.044715f * x * x * x); const float t = 1.0f - 2.0f / (1.0f + __expf(2.0f * y)); return 0.5f * x * (1.0f + t); }

namespace pg8 {
constexpr int BM = 256, BK = 64, HALF = 128, HTB = HALF * BK * 2, STAGE_BYTES = 8 * HTB, NXCD = 8, WGM = 8;
__host__ __device__ __forceinline__ int lds_byte(int r, int c) { const int st = (r >> 4) * 2 + (c >> 5), rr = r & 15, cc = c & 31, ob = rr * 64 + cc * 2; return st * 1024 + (ob ^ (((ob >> 9) & 1) << 5)); }
__host__ __device__ __forceinline__ void stage_rc(int b, int& R, int& C) { const int st = b / 1024, sb = b % 1024, swz = sb ^ (((sb >> 9) & 1) << 5); R = (st >> 1) * 16 + swz / 64; C = (st & 1) * 32 + (swz % 64) / 2; }
__host__ __device__ __forceinline__ int perm32(int rho) { const int n = rho >> 4, i = rho & 15; return 8 * (i >> 2) + 4 * n + (i & 3); }
struct Unit { int pm, pn; };
struct Gemm { const bf16_t* A; const bf16_t* Bt; int M, N, K; };
struct StaticOrder {
    int nM, nN, nwg, G, c;
    __device__ void init(int M_, int N_, int G_, int c_) { nM = M_ / BM; nN = N_ / BM; nwg = nM * nN; G = G_; c = c_; }
    __device__ bool next(int i, Unit& u) const {
        const long L = (long)i * G + c; if (L >= nwg) return false;
        int wgid = (int)L; { const int q = nwg / NXCD, r = nwg % NXCD, xcd = wgid % NXCD, off = wgid / NXCD; wgid = (xcd < r ? xcd * (q + 1) : r * (q + 1) + (xcd - r) * q) + off; }
        const int nig = WGM * nN, gid = wgid / nig, fm = gid * WGM, gsz = (nM - fm) < WGM ? (nM - fm) : WGM;
        u.pm = fm + ((wgid % nig) % gsz); u.pn = (wgid % nig) / gsz; return true;
    }
};
template <int MODE  > struct Epi {
    static constexpr bool PERM = true;
    bf16_t* O; int ldc;
    __device__ __forceinline__ void operator()(const f32x4 (&acc)[2][2][4][2], const Unit& u, int wr, int wc, int fr, int fq) const {
        const int row0 = u.pm * BM + wr * 64 + fr;
        if (MODE == 0) {
            const int col0 = u.pn * BM + wc * 32 + 8 * fq;
#pragma unroll
            for (int ai = 0; ai < 2; ++ai)
#pragma unroll
                for (int m = 0; m < 4; ++m) { bf16_t* rowp = O + (size_t)(row0 + ai * HALF + m * 16) * ldc + col0;
#pragma unroll
                    for (int bj = 0; bj < 2; ++bj) { const f32x4 v0 = acc[ai][bj][m][0], v1 = acc[ai][bj][m][1]; u32x4 w;
                        w.x = pk2(v0[0], v0[1]); w.y = pk2(v0[2], v0[3]); w.z = pk2(v1[0], v1[1]); w.w = pk2(v1[2], v1[3]); *(u32x4*)(rowp + bj * HALF) = w; } }
        } else {
            const int col0 = u.pn * HALF + wc * 32 + 8 * fq;
#pragma unroll
            for (int ai = 0; ai < 2; ++ai)
#pragma unroll
                for (int m = 0; m < 4; ++m) { bf16_t* rowp = O + (size_t)(row0 + ai * HALF + m * 16) * ldc + col0; float h[8];
#pragma unroll
                    for (int n = 0; n < 2; ++n)
#pragma unroll
                        for (int e = 0; e < 4; ++e) { const float g = acc[ai][0][m][n][e], up = acc[ai][1][m][n][e]; h[4 * n + e] = g * __builtin_amdgcn_rcpf(1.0f + __expf(-g)) * up; }
                    *(u32x4*)rowp = pack8(h); }
        }
    }
};

template <class EpiT>
__device__ __forceinline__ void gemm_phase(LAS unsigned char* lds, const Gemm g, const StaticOrder& S, const EpiT& E, const int tid) {
    const int wid = __builtin_amdgcn_readfirstlane(tid >> 6), lane = tid & 63, wr = wid >> 2, wc = wid & 3, fr = lane & 15, fq = lane >> 4;
    const int K = g.K, nt = K / BK;
    unsigned voffA[2], voffB[2];
#pragma unroll
    for (int i = 0; i < 2; ++i) { int R, C; stage_rc(tid * 16 + i * 8192, R, C); const int Rb = EpiT::PERM ? ((R & ~31) + perm32(R & 31)) : R;
        voffA[i] = (unsigned)(R * K + C) * 2u; voffB[i] = (unsigned)(Rb * K + C) * 2u; }
    const size_t kstep = (size_t)(BK * 2);
    const size_t hstep = (size_t)HALF * K * 2;
    const size_t tstep = 2 * hstep;
    const unsigned ldsw = (unsigned)wid * 1024u;
    const int aoff = lds_byte(wr * 64 + fr, fq * 8), boff = lds_byte(wc * 32 + fr, fq * 8);
#define PG8_SA(b, h) (((b) * 2 + (h)) * HTB)
#define PG8_SB(b, h) ((4 + (b) * 2 + (h)) * HTB)
#define PG8_STAGE(bufoff, gbase, voff) do { _Pragma("unroll") for (int _i = 0; _i < 2; ++_i) \
        __builtin_amdgcn_global_load_lds((const unsigned*)((const char*)(gbase) + (voff)[_i]), (LAS unsigned*)(lds + (bufoff) + ldsw + _i * 8192), 16, 0, 0); } while (0)
#define PG8_LDA(dst, b, h) do { _Pragma("unroll") for (int m = 0; m < 4; ++m) _Pragma("unroll") for (int k = 0; k < 2; ++k) dst[m][k] = *(const LAS bf16x8*)(lds + PG8_SA(b, h) + aoff + m * 2048 + k * 1024); } while (0)
#define PG8_LDB(dst, b, h) do { _Pragma("unroll") for (int n = 0; n < 2; ++n) _Pragma("unroll") for (int k = 0; k < 2; ++k) dst[n][k] = *(const LAS bf16x8*)(lds + PG8_SB(b, h) + boff + n * 2048 + k * 1024); } while (0)
#define PG8_MMA(ai, bj, At, Bt) do { __builtin_amdgcn_s_setprio(1); _Pragma("unroll") for (int m = 0; m < 4; ++m) _Pragma("unroll") for (int n = 0; n < 2; ++n) _Pragma("unroll") for (int k = 0; k < 2; ++k) \
        acc[ai][bj][m][n] = __builtin_amdgcn_mfma_f32_16x16x32_bf16(Bt[n][k], At[m][k], acc[ai][bj][m][n], 0, 0, 0); __builtin_amdgcn_s_setprio(0); } while (0)
#define PG8_WAIT_V(n) asm volatile("s_waitcnt vmcnt(" #n ")" ::: "memory")
#define PG8_WAIT_L(n) asm volatile("s_waitcnt lgkmcnt(" #n ")" ::: "memory")
#define PG8_BAR __builtin_amdgcn_s_barrier()
#define PG8_SCHED __builtin_amdgcn_sched_barrier(0)
    Unit cur, nxt; int ui = 0;
    if (!S.next(0, cur)) return;
    f32x4 acc[2][2][4][2];
#pragma unroll
    for (int a = 0; a < 2; ++a)
#pragma unroll
        for (int b = 0; b < 2; ++b)
#pragma unroll
            for (int m = 0; m < 4; ++m)
#pragma unroll
                for (int n = 0; n < 2; ++n) acc[a][b][m][n] = (f32x4){0.f, 0.f, 0.f, 0.f};
    bf16x8 At[4][2], B0[2][2], B1[2][2];
    const char* cA = (const char*)g.A + (size_t)cur.pm * tstep; const char* cB = (const char*)g.Bt + (size_t)cur.pn * tstep;
    PG8_STAGE(PG8_SB(0, 0), cB, voffB); PG8_STAGE(PG8_SB(0, 1), cB + hstep, voffB); PG8_STAGE(PG8_SA(0, 0), cA, voffA); PG8_STAGE(PG8_SA(0, 1), cA + hstep, voffA);
    if (wr == 1) PG8_BAR;
    PG8_WAIT_V(2); PG8_BAR;
    PG8_STAGE(PG8_SB(1, 0), cB + kstep, voffB); PG8_STAGE(PG8_SA(1, 0), cA + kstep, voffA); PG8_STAGE(PG8_SB(1, 1), cB + hstep + kstep, voffB);
    PG8_WAIT_V(6); PG8_BAR;
    for (;;) {
        const bool has_next = S.next(ui + 1, nxt);
        const char* nA = has_next ? (const char*)g.A + (size_t)nxt.pm * tstep : cA; const char* nB = has_next ? (const char*)g.Bt + (size_t)nxt.pn * tstep : cB;
        for (int t = 0; t < nt; t += 2) {
            const bool last = (t == nt - 2);
            const char* a1 = cA + (size_t)(t + 1) * kstep;
            const char* a2 = last ? nA : cA + (size_t)(t + 2) * kstep; const char* b2 = last ? nB : cB + (size_t)(t + 2) * kstep;
            const char* a3 = a2 + kstep; const char* b3 = b2 + kstep;
            PG8_LDB(B0, 0, 0); PG8_LDB(B1, 0, 1); PG8_SCHED; PG8_LDA(At, 0, 0); PG8_STAGE(PG8_SA(1, 1), a1 + hstep, voffA);
            PG8_WAIT_V(8); PG8_WAIT_L(0); PG8_BAR; PG8_MMA(0, 0, At, B0); PG8_MMA(0, 1, At, B1); PG8_BAR; PG8_SCHED;
            PG8_LDA(At, 0, 1); PG8_STAGE(PG8_SB(0, 0), b2, voffB); PG8_STAGE(PG8_SB(0, 1), b2 + hstep, voffB); PG8_STAGE(PG8_SA(0, 0), a2, voffA);
            PG8_WAIT_V(8); PG8_WAIT_L(0); PG8_BAR; PG8_MMA(1, 0, At, B0); PG8_MMA(1, 1, At, B1); PG8_BAR; PG8_SCHED;
            PG8_LDB(B0, 1, 0); PG8_LDB(B1, 1, 1); PG8_SCHED; PG8_LDA(At, 1, 0); PG8_STAGE(PG8_SA(0, 1), a2 + hstep, voffA);
            PG8_WAIT_V(8); PG8_WAIT_L(0); PG8_BAR; PG8_MMA(0, 0, At, B0); PG8_MMA(0, 1, At, B1); PG8_BAR; PG8_SCHED;
            PG8_LDA(At, 1, 1); PG8_STAGE(PG8_SB(1, 0), b3, voffB); PG8_STAGE(PG8_SB(1, 1), b3 + hstep, voffB); PG8_STAGE(PG8_SA(1, 0), a3, voffA);
            PG8_WAIT_V(8); PG8_WAIT_L(0); PG8_BAR; PG8_MMA(1, 0, At, B0); PG8_MMA(1, 1, At, B1); PG8_BAR; PG8_SCHED;
        }
        if (wr == 0) PG8_BAR;
        E(acc, cur, wr, wc, fr, fq);
        if (!has_next) break;
#pragma unroll
        for (int a = 0; a < 2; ++a)
#pragma unroll
            for (int b = 0; b < 2; ++b)
#pragma unroll
                for (int m = 0; m < 4; ++m)
#pragma unroll
                    for (int n = 0; n < 2; ++n) acc[a][b][m][n] = (f32x4){0.f, 0.f, 0.f, 0.f};
        cur = nxt; cA = nA; cB = nB; ++ui;
        if (wr == 1) PG8_BAR;
    }
    PG8_WAIT_V(0);
    PG8_BAR;
#undef PG8_SA
#undef PG8_SB
#undef PG8_STAGE
#undef PG8_LDA
#undef PG8_LDB
#undef PG8_MMA
#undef PG8_WAIT_V
#undef PG8_WAIT_L
#undef PG8_BAR
#undef PG8_SCHED
}
}

#define XB_TMO      128
#define XB_XCNT(j)  (256  + 64 * (j))
#define XB_XSUB(j)  (1280 + 64 * (j))
#define XB_XGEN(j)  (2304 + 64 * (j))
#define XB_TOP      3328
#define XB_TOPGEN   3392
#define XCD_BAR_WORDS 3456
#define XB_SPIN_CAP (1u << 22)
__device__ __forceinline__ unsigned xb_ld(unsigned* p)              { return __hip_atomic_load(p, __ATOMIC_RELAXED, __HIP_MEMORY_SCOPE_AGENT); }
__device__ __forceinline__ unsigned xb_add(unsigned* p, unsigned v) { return __hip_atomic_fetch_add(p, v, __ATOMIC_RELAXED, __HIP_MEMORY_SCOPE_AGENT); }
__device__ __forceinline__ unsigned xb_xcc_id() { return (unsigned)__builtin_amdgcn_s_getreg((3 << 11) | 20) & 0xFu; }
#define XB_SPIN(cond, bar) do { unsigned _sp = 0; while (cond) { __builtin_amdgcn_s_sleep(1); \
    if ((++_sp & 255u) == 0u) { if (xb_ld(&(bar)[XB_TMO])) break; if (_sp > XB_SPIN_CAP) { atomicAdd(&(bar)[XB_TMO], 1u); break; } } } } while (0)
struct XcdBarrier { unsigned* bar; unsigned x; volatile LAS unsigned* st; };
__device__ __forceinline__ XcdBarrier xcd_barrier_post(unsigned* bar, volatile LAS unsigned* st) {
    XcdBarrier b; b.bar = bar; b.x = xb_xcc_id(); b.st = st;
    if (threadIdx.x == 0) (void)xb_add(&bar[XB_XCNT(b.x)], 1u);
    return b;
}
__device__ __forceinline__ void xcd_barrier_complete(unsigned* bar, unsigned x, unsigned& nloc, unsigned& nx) {
    const unsigned G = gridDim.x * gridDim.y * gridDim.z;
    unsigned sum, cnt, mine, sp = 0u;
    for (;;) {
        sum = 0u; cnt = 0u; mine = 0u;
#pragma unroll
        for (unsigned j = 0; j < 16; ++j) { const unsigned c = xb_ld(&bar[XB_XCNT(j)]); sum += c; cnt += (c > 0u) ? 1u : 0u; mine = (j == x) ? c : mine; }
        if (sum == G) break;
        __builtin_amdgcn_s_sleep(1);
        if ((++sp & 255u) == 0u) { if (xb_ld(&bar[XB_TMO])) break; if (sp > XB_SPIN_CAP) { atomicAdd(&bar[XB_TMO], 1u); break; } }
    }
    nloc = mine > 0u ? mine : 1u; nx = cnt > 0u ? cnt : 1u;
}
__device__ __forceinline__ void xcd_barrier(const XcdBarrier& b) {
    asm volatile("s_waitcnt vmcnt(0)" ::: "memory");
    __syncthreads();
    if (threadIdx.x == 0) {
        unsigned* bar = b.bar;
        __builtin_amdgcn_s_waitcnt(0);
        unsigned nloc = b.st[0], nx = b.st[1];
        if (nloc == 0u) { xcd_barrier_complete(bar, b.x, nloc, nx); b.st[0] = nloc; b.st[1] = nx; }
        const unsigned old = xb_add(&bar[XB_XSUB(b.x)], 1u);
        const unsigned gen = old / nloc;
        if (old + 1u == (gen + 1u) * nloc) {
            __builtin_amdgcn_fence(__ATOMIC_RELEASE, "agent");
            asm volatile("s_waitcnt vmcnt(0)" ::: "memory");
            const unsigned og = xb_add(&bar[XB_TOP], 1u);
            const unsigned tg = og / nx;
            if (og + 1u == (tg + 1u) * nx) xb_add(&bar[XB_TOPGEN], 1u);
            else XB_SPIN(xb_ld(&bar[XB_TOPGEN]) == tg, bar);
            __builtin_amdgcn_fence(__ATOMIC_ACQUIRE, "agent");
            xb_add(&bar[XB_XGEN(b.x)], 1u);
            asm volatile("s_waitcnt vmcnt(0)" ::: "memory");
        } else {
            XB_SPIN(xb_ld(&bar[XB_XGEN(b.x)]) == gen, bar);
            __builtin_amdgcn_fence(__ATOMIC_ACQUIRE, "agent");
            asm volatile("s_waitcnt vmcnt(0)" ::: "memory");
        }
    }
    __syncthreads();
}

__device__ __forceinline__ void transpose_item(const float* W, int K, int N, bf16_t* WT, int mode, LAS float* scr, int item, int lane) {
    const int nblk = N / 32, kb = item / nblk, nb = item % nblk, k0 = 64 * kb, n0 = 32 * nb;
#pragma unroll 8
    for (int i = 0; i < 32; ++i) { const int kk = 2 * i + (lane >> 5); scr[kk * 33 + (lane & 31)] = W[(size_t)(k0 + kk) * N + n0 + (lane & 31)]; }
    asm volatile("s_waitcnt lgkmcnt(0)" ::: "memory");
    const int c = lane & 7;
    const int r0 = (mode == 0) ? n0 : ((n0 >> 7) * 256 + (mode == 2 ? 128 : 0) + (n0 & 127));
#pragma unroll
    for (int j = 0; j < 4; ++j) { const int n = (lane >> 3) + 8 * j; const LAS float* s = scr + (8 * c) * 33 + n;
        u32x4 o; o.x = pk2(s[0 * 33], s[1 * 33]); o.y = pk2(s[2 * 33], s[3 * 33]); o.z = pk2(s[4 * 33], s[5 * 33]); o.w = pk2(s[6 * 33], s[7 * 33]);
        *(u32x4*)(WT + (size_t)(r0 + n) * K + k0 + 8 * c) = o; }
    asm volatile("s_waitcnt lgkmcnt(0)" ::: "memory");
}

struct Args { const float* in[30]; float* out; unsigned char* ws; };

__device__ __forceinline__ void elem_phase(float* X, const bf16_t* Y, bf16_t* XN, const float* gpost, const float* gpre, float coef, int gw, int ngw, int lane) {
    for (int m = gw; m < M; m += ngw) {
        f32x4* xr = (f32x4*)(X + (size_t)m * DM) + lane;
        const u32x2* yr = (const u32x2*)(Y + (size_t)m * DM) + lane;
        f32x4 xv[4], yv[4]; float ss = 0.f;
#pragma unroll
        for (int j = 0; j < 4; ++j) { xv[j] = xr[64 * j]; const u32x2 w = yr[64 * j]; yv[j] = (f32x4){bflo(w.x), bfhi(w.x), bflo(w.y), bfhi(w.y)};
            ss += (yv[j][0] * yv[j][0] + yv[j][1] * yv[j][1]) + (yv[j][2] * yv[j][2] + yv[j][3] * yv[j][3]); }
        const float rs = coef / sqrtf(wave_sum(ss) * (1.0f / DM) + EPS);
        float s2 = 0.f;
#pragma unroll
        for (int j = 0; j < 4; ++j) { const f32x4 g = ((const f32x4*)gpost)[lane + 64 * j]; xv[j] = xv[j] + yv[j] * g * rs; xr[64 * j] = xv[j];
            s2 += (xv[j][0] * xv[j][0] + xv[j][1] * xv[j][1]) + (xv[j][2] * xv[j][2] + xv[j][3] * xv[j][3]); }
        if (gpre) {
            const float r2 = 1.0f / sqrtf(wave_sum(s2) * (1.0f / DM) + EPS);
            u32x2* o = (u32x2*)(XN + (size_t)m * DM) + lane;
#pragma unroll
            for (int j = 0; j < 4; ++j) { const f32x4 g = ((const f32x4*)gpre)[lane + 64 * j]; const f32x4 v = xv[j] * g * r2; u32x2 w; w.x = pk2(v[0], v[1]); w.y = pk2(v[2], v[3]); o[64 * j] = w; }
        }
    }
}

#define MFMA32(a, b, c) __builtin_amdgcn_mfma_f32_32x32x16_bf16((a), (b), (c), 0, 0, 0)
__device__ __forceinline__ int crow(int r, int h) { return (r & 3) + 8 * (r >> 2) + 4 * h; }
constexpr int KST = 144, VST = 528;
__device__ __forceinline__ void attn_prompt_unit(LAS unsigned char* lds, int unit, const bf16_t* Z, bf16_t* ATTO, const float* sinks, float* newk, float* newv, int tid) {
    const int kvh = unit & 1, qb = (unit >> 1) & 63, b = unit >> 7;
    LAS unsigned char* Kl = lds; LAS unsigned char* Vl = lds + 256 * KST;
    {
        const int key = tid >> 1, half = tid & 1; const int pos = 128 * qb - 128 + key;
        u32x4 kq[4], vq[4];
        if (pos >= 0) {
            const bf16_t* zr = Z + (size_t)(b * SEQ + pos) * NIN;
            const u32x4* kp = (const u32x4*)(zr + K_OFF + 64 * kvh + 32 * half); const u32x4* vp = (const u32x4*)(zr + V_OFF + 64 * kvh + 32 * half);
#pragma unroll
            for (int i = 0; i < 4; ++i) { kq[i] = kp[i]; vq[i] = vp[i]; }
            if (half == 0) rope8(kq[0], kq[1], (float)pos);
        } else {
#pragma unroll
            for (int i = 0; i < 4; ++i) { kq[i] = (u32x4){0u, 0u, 0u, 0u}; vq[i] = (u32x4){0u, 0u, 0u, 0u}; }
        }
#pragma unroll
        for (int i = 0; i < 4; ++i) *(LAS u32x4*)(Kl + key * KST + half * 64 + i * 16) = kq[i];
#pragma unroll
        for (int i = 0; i < 4; ++i) {
            const unsigned w4[4] = {vq[i].x, vq[i].y, vq[i].z, vq[i].w};
#pragma unroll
            for (int e = 0; e < 8; ++e) { const unsigned short val = (unsigned short)((e & 1) ? (w4[e >> 1] >> 16) : (w4[e >> 1] & 0xffffu));
                *(LAS unsigned short*)(Vl + (32 * half + 8 * i + e) * VST + key * 2) = val; }
        }
        if (qb == 63 && key >= 128) {
            float* ok = newk + ((size_t)(b * 128 + key - 128) * 2 + kvh) * 64 + 32 * half; float* ov = newv + ((size_t)(b * 128 + key - 128) * 2 + kvh) * 64 + 32 * half;
#pragma unroll
            for (int i = 0; i < 4; ++i) { float f[8]; unpack8(kq[i], f); *(f32x4*)(ok + 8 * i) = (f32x4){f[0], f[1], f[2], f[3]}; *(f32x4*)(ok + 8 * i + 4) = (f32x4){f[4], f[5], f[6], f[7]};
                unpack8(vq[i], f); *(f32x4*)(ov + 8 * i) = (f32x4){f[0], f[1], f[2], f[3]}; *(f32x4*)(ov + 8 * i + 4) = (f32x4){f[4], f[5], f[6], f[7]}; }
        }
    }
    __syncthreads();
    const int w = tid >> 6, lane = tid & 63, q32 = lane & 31, hi = lane >> 5;
    const int hq = 4 * kvh + (w >> 1);
    const float sink = sinks[hq];
#pragma unroll 1
    for (int i = 0; i < 2; ++i) {
        const int qi = 64 * (w & 1) + 32 * i + q32, at = 2 * (w & 1) + i;
        const int pos = 128 * qb + qi; const size_t row = (size_t)b * SEQ + pos;
        const bf16_t* zq = Z + row * NIN + 64 * hq;
        bf16x8 qf[4];
        {
            u32x4 c0 = *(const u32x4*)(zq), c1 = *(const u32x4*)(zq + 8);
            rope8(c0, c1, (float)pos);
            u32x4 mine = hi ? c1 : c0; float f[8]; unpack8(mine, f);
#pragma unroll
            for (int e = 0; e < 8; ++e) f[e] *= 0.125f;
            qf[0] = __builtin_bit_cast(bf16x8, pack8(f));
#pragma unroll
            for (int s = 1; s < 4; ++s) { const u32x4 c = *(const u32x4*)(zq + 16 * s + 8 * hi); unpack8(c, f);
#pragma unroll
                for (int e = 0; e < 8; ++e) f[e] *= 0.125f;
                qf[s] = __builtin_bit_cast(bf16x8, pack8(f)); }
        }
        f32x16 acc[5];
#pragma unroll
        for (int j = 0; j < 5; ++j) {
#pragma unroll
            for (int r = 0; r < 16; ++r) acc[j][r] = 0.f;
#pragma unroll
            for (int s = 0; s < 4; ++s) { const bf16x8 kf = *(const LAS bf16x8*)(Kl + (32 * (at + j) + q32) * KST + (16 * s + 8 * hi) * 2); acc[j] = MFMA32(kf, qf[s], acc[j]); }
        }
        float mx = sink;
#pragma unroll
        for (int j = 0; j < 5; ++j)
#pragma unroll
            for (int r = 0; r < 16; ++r) { const int kj = 32 * (at + j) + crow(r, hi); const int diff = kj - qi; const bool ok = (diff >= 1) && (diff <= 128) && (qb > 0 || kj >= 128);
                const float v = ok ? acc[j][r] : -INFINITY; acc[j][r] = v; mx = fmaxf(mx, v); }
        mx = fmaxf(mx, __shfl_xor(mx, 32));
        float sum = 0.f;
#pragma unroll
        for (int j = 0; j < 5; ++j)
#pragma unroll
            for (int r = 0; r < 16; ++r) { const float p = __expf(acc[j][r] - mx); acc[j][r] = p; sum += p; }
        sum += __shfl_xor(sum, 32); sum += __expf(sink - mx);
        const float inv = 1.0f / sum;
        f32x16 o[2];
#pragma unroll
        for (int dt = 0; dt < 2; ++dt)
#pragma unroll
            for (int r = 0; r < 16; ++r) o[dt][r] = 0.f;
#pragma unroll
        for (int j = 0; j < 5; ++j)
#pragma unroll
            for (int s2 = 0; s2 < 2; ++s2) {
                u32x4 pw; pw.x = pk2(acc[j][8 * s2 + 0], acc[j][8 * s2 + 1]); pw.y = pk2(acc[j][8 * s2 + 2], acc[j][8 * s2 + 3]); pw.z = pk2(acc[j][8 * s2 + 4], acc[j][8 * s2 + 5]); pw.w = pk2(acc[j][8 * s2 + 6], acc[j][8 * s2 + 7]);
                const bf16x8 pf = __builtin_bit_cast(bf16x8, pw);
#pragma unroll
                for (int dt = 0; dt < 2; ++dt) { const LAS unsigned char* vp = Vl + (32 * dt + q32) * VST + (32 * (at + j) + 16 * s2 + 4 * hi) * 2;
                    const s16x4 lo = *(const LAS s16x4*)vp; const s16x4 h4 = *(const LAS s16x4*)(vp + 16);
                    const bf16x8 vf = __builtin_shufflevector(lo, h4, 0, 1, 2, 3, 4, 5, 6, 7);
                    o[dt] = MFMA32(vf, pf, o[dt]); }
            }
        bf16_t* orow = ATTO + row * AW + 64 * hq;
#pragma unroll
        for (int dt = 0; dt < 2; ++dt)
#pragma unroll
            for (int g = 0; g < 4; ++g) { u32x2 wv; wv.x = pk2(o[dt][4 * g] * inv, o[dt][4 * g + 1] * inv); wv.y = pk2(o[dt][4 * g + 2] * inv, o[dt][4 * g + 3] * inv);
                *(u32x2*)(orow + 32 * dt + 8 * g + 4 * hi) = wv; }
    }
    __syncthreads();
}

__device__ __forceinline__ void attn_sample_unit(LAS unsigned char* lds, int unit, int layer, const bf16_t* Z, bf16_t* ATTO, const float* sinks, const float* cache_k, const float* cache_v, float* newk, float* newv, int tid) {
    const int kvh = unit & 1, b = unit >> 1;
    LAS float* Kf = (LAS float*)lds;
    LAS float* Vf = Kf + 132 * 65;
    LAS float* Qf = Vf + 132 * 64;
    LAS float* Sf = Qf + 16 * 64;
    const size_t cbase = ((size_t)(layer * DB + b) * 128) * 128 + kvh * 64;
    for (int idx = tid; idx < 128 * 16; idx += 512) { const int j = idx >> 4, d4 = (idx & 15) * 4;
        const f32x4 kv = *(const f32x4*)(cache_k + cbase + (size_t)j * 128 + d4); const f32x4 vv = *(const f32x4*)(cache_v + cbase + (size_t)j * 128 + d4);
#pragma unroll
        for (int e = 0; e < 4; ++e) { Kf[j * 65 + d4 + e] = kv[e]; Vf[j * 64 + d4 + e] = vv[e]; } }
    if (tid < 256) { const int t = tid >> 6, d = tid & 63; const bf16_t* zr = Z + (size_t)(MP + 4 * b + t) * NIN;
        float kx = bf2f(zr[K_OFF + 64 * kvh + d]);
        if (d < 16) { const int e = d & 7; float s, c; sincos_pos((float)(PAST + t), e, s, c);
            const float x1 = bf2f(zr[K_OFF + 64 * kvh + e]), x2 = bf2f(zr[K_OFF + 64 * kvh + e + 8]); kx = (d < 8) ? (x1 * c - x2 * s) : (x2 * c + x1 * s); }
        Kf[(128 + t) * 65 + d] = kx; Vf[(128 + t) * 64 + d] = bf2f(zr[V_OFF + 64 * kvh + d]); }
    for (int idx = tid; idx < 1024; idx += 512) { const int qr = idx >> 6, d = idx & 63, g = qr >> 2, t = qr & 3; const bf16_t* zr = Z + (size_t)(MP + 4 * b + t) * NIN + 64 * (4 * kvh + g);
        float qx = bf2f(zr[d]);
        if (d < 16) { const int e = d & 7; float s, c; sincos_pos((float)(PAST + t), e, s, c); const float x1 = bf2f(zr[e]), x2 = bf2f(zr[e + 8]); qx = (d < 8) ? (x1 * c - x2 * s) : (x2 * c + x1 * s); }
        Qf[qr * 64 + d] = qx * 0.125f; }
    __syncthreads();
    for (int idx = tid; idx < 128 * 16; idx += 512) { const int j = idx >> 4, d4 = (idx & 15) * 4; const size_t o = ((size_t)(b * 128 + j) * 2 + kvh) * 64 + d4;
        *(f32x4*)(newk + o) = (f32x4){Kf[(j + 4) * 65 + d4], Kf[(j + 4) * 65 + d4 + 1], Kf[(j + 4) * 65 + d4 + 2], Kf[(j + 4) * 65 + d4 + 3]};
        *(f32x4*)(newv + o) = (f32x4){Vf[(j + 4) * 64 + d4], Vf[(j + 4) * 64 + d4 + 1], Vf[(j + 4) * 64 + d4 + 2], Vf[(j + 4) * 64 + d4 + 3]}; }
    for (int idx = tid; idx < 16 * 132; idx += 512) { const int qr = idx / 132, kj = idx - qr * 132, t = qr & 3;
        float s = 0.f;
#pragma unroll 16
        for (int d = 0; d < 64; ++d) s += Qf[qr * 64 + d] * Kf[kj * 65 + d];
        const bool ok = (kj < 128) ? (kj > t) : (kj - 128 <= t);
        Sf[qr * 136 + kj] = ok ? s : -INFINITY; }
    __syncthreads();
    { const int w = tid >> 6, lane = tid & 63;
#pragma unroll
        for (int rr = 0; rr < 2; ++rr) { const int qr = 2 * w + rr; const float sink = sinks[4 * kvh + (qr >> 2)];
            float v[3]; float mx = sink;
#pragma unroll
            for (int c = 0; c < 3; ++c) { const int kj = lane + 64 * c; v[c] = (kj < 132) ? Sf[qr * 136 + kj] : -INFINITY; mx = fmaxf(mx, v[c]); }
#pragma unroll
            for (int o = 1; o < 64; o <<= 1) mx = fmaxf(mx, __shfl_xor(mx, o));
            float sum = 0.f;
#pragma unroll
            for (int c = 0; c < 3; ++c) { v[c] = __expf(v[c] - mx); sum += v[c]; }
            sum = wave_sum(sum) + __expf(sink - mx); const float inv = 1.0f / sum;
#pragma unroll
            for (int c = 0; c < 3; ++c) { const int kj = lane + 64 * c; if (kj < 132) Sf[qr * 136 + kj] = v[c] * inv; } } }
    __syncthreads();
    { const int d = tid & 63;
#pragma unroll
        for (int i = 0; i < 2; ++i) { const int qr = (tid >> 6) + 8 * i; float o = 0.f;
            for (int kj = 0; kj < 132; ++kj) o += Sf[qr * 136 + kj] * Vf[kj * 64 + d];
            const int g = qr >> 2, t = qr & 3; ATTO[(size_t)(MP + 4 * b + t) * AW + 64 * (4 * kvh + g) + d] = (bf16_t)(pk2(o, 0.f) & 0xffffu); } }
    __syncthreads();
}

constexpr int XST = 1040;
__device__ __forceinline__ void lru_prompt_unit(LAS unsigned char* lds, int unit, const bf16_t* Z, const float* conv_w, const float* conv_b, const bf16_t* Wat, const bf16_t* Wxt,
                                                const float* ga_b, const float* gx_b, const float* lam, bf16_t* HL, bf16_t* PP, float* SUM, float* newconv, int tid) {
    const int b = unit / NCH, c = unit % NCH, t0 = c * CH;
    LAS unsigned char* XC = lds;
    {
        const int c8 = (tid & 63) * 8;
        float w[4][8], bias[8];
#pragma unroll
        for (int j = 0; j < 4; ++j) { const f32x4 a = *(const f32x4*)(conv_w + j * LW + c8), bb = *(const f32x4*)(conv_w + j * LW + c8 + 4);
#pragma unroll
            for (int e = 0; e < 4; ++e) { w[j][e] = a[e]; w[j][4 + e] = bb[e]; } }
        { const f32x4 a = *(const f32x4*)(conv_b + c8), bb = *(const f32x4*)(conv_b + c8 + 4);
#pragma unroll
            for (int e = 0; e < 4; ++e) { bias[e] = a[e]; bias[4 + e] = bb[e]; } }
#pragma unroll 2
        for (int i = 0; i < 8; ++i) { const int tl = (tid >> 6) + 8 * i, t = t0 + tl;
            float accv[8];
#pragma unroll
            for (int e = 0; e < 8; ++e) accv[e] = bias[e];
#pragma unroll
            for (int j = 0; j < 4; ++j) { const int tt = t + j - 3;
                if (tt >= 0) { const u32x4 x = *(const u32x4*)(Z + (size_t)(b * SEQ + tt) * NIN + XR_OFF + c8); float f[8]; unpack8(x, f);
#pragma unroll
                    for (int e = 0; e < 8; ++e) accv[e] += w[j][e] * f[e];
                    if (c == NCH - 1 && j == 3 && tl >= CH - 3) { float* o = newconv + ((size_t)b * 3 + (tl - (CH - 3))) * LW + c8;
                        *(f32x4*)o = (f32x4){f[0], f[1], f[2], f[3]}; *(f32x4*)(o + 4) = (f32x4){f[4], f[5], f[6], f[7]}; } } }
            *(LAS u32x4*)(XC + tl * XST + c8 * 2) = pack8(accv); }
    }
    __syncthreads();
    const int w = tid >> 6, lane = tid & 63, q32 = lane & 31, hi = lane >> 5;
#pragma unroll 1
    for (int ct = 0; ct < 2; ++ct) {
        const int cch = 64 * w + 32 * ct + q32;
        const float ba = ga_b[cch], bx = gx_b[cch]; const float sp = log1pf(__expf(-lam[cch]));
        bf16x8 wa[4], wx[4];
#pragma unroll
        for (int s = 0; s < 4; ++s) { wa[s] = *(const bf16x8*)(Wat + (size_t)(w * 64 + 32 * ct + q32) * 64 + 16 * s + 8 * hi); wx[s] = *(const bf16x8*)(Wxt + (size_t)(w * 64 + 32 * ct + q32) * 64 + 16 * s + 8 * hi); }
        float Pc = 1.f, hc = 0.f;
#pragma unroll 1
        for (int rt = 0; rt < 2; ++rt) {
            f32x16 aR, aI;
#pragma unroll
            for (int r = 0; r < 16; ++r) { aR[r] = 0.f; aI[r] = 0.f; }
#pragma unroll
            for (int s = 0; s < 4; ++s) { const bf16x8 xf = *(const LAS bf16x8*)(XC + (32 * rt + q32) * XST + (64 * w + 16 * s + 8 * hi) * 2); aR = MFMA32(xf, wa[s], aR); aI = MFMA32(xf, wx[s], aI); }
            float av[16], uv[16];
#pragma unroll
            for (int r = 0; r < 16; ++r) { const int tl = 32 * rt + crow(r, hi); const float xcv = bf2f(*(const LAS unsigned short*)(XC + tl * XST + cch * 2));
                const float rg = sigmoidf_(aR[r] + ba), ig = sigmoidf_(aI[r] + bx); const float la = -8.0f * rg * sp; const float a = __expf(la);
                av[r] = a; uv[r] = sqrtf(fmaxf(1.0f - a * a, 0.f)) * ig * xcv; }
            float As[4], Hs[4], AsO[4], HsO[4];
#pragma unroll
            for (int g = 0; g < 4; ++g) { float Pl = 1.f, hl = 0.f;
#pragma unroll
                for (int e = 0; e < 4; ++e) { const int r = 4 * g + e; hl = av[r] * hl + uv[r]; Pl *= av[r]; av[r] = Pl; uv[r] = hl; }
                As[g] = Pl; Hs[g] = hl; AsO[g] = __shfl_xor(Pl, 32); HsO[g] = __shfl_xor(hl, 32); }
#pragma unroll
            for (int g = 0; g < 4; ++g) {
                const float A0 = hi ? AsO[g] : As[g], H0 = hi ? HsO[g] : Hs[g], A1 = hi ? As[g] : AsO[g], H1 = hi ? Hs[g] : HsO[g];
                const float Pst = hi ? A0 * Pc : Pc, hst = hi ? (A0 * hc + H0) : hc;
#pragma unroll
                for (int e = 0; e < 4; ++e) { const int r = 4 * g + e; const float Pt = av[r] * Pst, ht = uv[r] + av[r] * hst; const size_t row = (size_t)b * SEQ + t0 + 32 * rt + crow(r, hi);
                    HL[row * LW + cch] = (bf16_t)(pk2(ht, 0.f) & 0xffffu); PP[row * LW + cch] = (bf16_t)(pk2(Pt, 0.f) & 0xffffu); }
                hc = A0 * hc + H0; Pc = A0 * Pc; hc = A1 * hc + H1; Pc = A1 * Pc;
            }
        }
        if (hi == 0) { SUM[((size_t)(b * NCH + c) * 2 + 0) * LW + cch] = Pc; SUM[((size_t)(b * NCH + c) * 2 + 1) * LW + cch] = hc; }
    }
    __syncthreads();
}

__device__ __forceinline__ void lru_sample_unit(LAS unsigned char* lds, int b, const bf16_t* Z, const float* conv_w, const float* conv_b, const float* gaw, const float* gxw,
                                                const float* ga_b, const float* gx_b, const float* lam, const float* st_conv, const float* st_h, bf16_t* HL, bf16_t* PP, float* newconv, float* newh, int tid) {
    LAS float* xcl = (LAS float*)lds;
    const int ch = tid;
    float xp[7];
#pragma unroll
    for (int j = 0; j < 3; ++j) xp[j] = st_conv[((size_t)b * 3 + j) * LW + ch];
#pragma unroll
    for (int t = 0; t < 4; ++t) xp[3 + t] = bf2f(Z[(size_t)(MP + 4 * b + t) * NIN + XR_OFF + ch]);
    float wj[4];
#pragma unroll
    for (int j = 0; j < 4; ++j) wj[j] = conv_w[j * LW + ch];
    const float cb = conv_b[ch];
    float xc[4];
#pragma unroll
    for (int t = 0; t < 4; ++t) { xc[t] = cb + xp[t] * wj[0] + xp[t + 1] * wj[1] + xp[t + 2] * wj[2] + xp[t + 3] * wj[3]; xcl[t * LW + ch] = xc[t]; }
#pragma unroll
    for (int j = 0; j < 3; ++j) newconv[((size_t)b * 3 + j) * LW + ch] = xp[4 + j];
    __syncthreads();
    const int h = ch >> 6, jj = ch & 63;
    float ra[4] = {0.f, 0.f, 0.f, 0.f}, rx[4] = {0.f, 0.f, 0.f, 0.f};
    for (int i = 0; i < 64; ++i) { const float wa = gaw[(size_t)(h * 64 + i) * 64 + jj], wx = gxw[(size_t)(h * 64 + i) * 64 + jj];
#pragma unroll
        for (int t = 0; t < 4; ++t) { const float x = xcl[t * LW + h * 64 + i]; ra[t] += x * wa; rx[t] += x * wx; } }
    const float ba = ga_b[ch], bx = gx_b[ch], sp = log1pf(__expf(-lam[ch]));
    float hh = st_h[(size_t)b * LW + ch];
#pragma unroll
    for (int t = 0; t < 4; ++t) { const float rg = sigmoidf_(ra[t] + ba), ig = sigmoidf_(rx[t] + bx); const float la = -8.0f * rg * sp; const float a = __expf(la);
        hh = a * hh + sqrtf(fmaxf(1.0f - a * a, 0.f)) * ig * xc[t];
        const size_t row = (size_t)MP + 4 * b + t; HL[row * LW + ch] = (bf16_t)(pk2(hh, 0.f) & 0xffffu); PP[row * LW + ch] = 0; }
    newh[(size_t)b * LW + ch] = hh;
    __syncthreads();
}

__device__ __forceinline__ void mix_final_unit(LAS unsigned char* lds, int unit, const bf16_t* Z, const bf16_t* ATTO, const bf16_t* HL, const bf16_t* PP, const float* SUM,
                                               const float* g_attn, const float* g_lru, bf16_t* MIX, float* newh_p, int tid) {
    LAS float* hin = (LAS float*)lds;
    const bool prompt = unit < NB * NCH;
    const int b = unit / NCH, c = unit % NCH;
    {
        float h = 0.f;
        if (prompt) {
            const float* sb = SUM + (size_t)(b * NCH) * 2 * LW + tid;
            for (int cc = 0; cc < c; ++cc) { const float A = sb[(size_t)cc * 2 * LW], H = sb[(size_t)cc * 2 * LW + LW]; h = A * h + H; }
            if (c == NCH - 1) { const float A = sb[(size_t)c * 2 * LW], H = sb[(size_t)c * 2 * LW + LW]; newh_p[(size_t)b * LW + tid] = A * h + H; }
        }
        hin[tid] = h;
    }
    __syncthreads();
    const int w = tid >> 6, lane = tid & 63, c8 = lane * 8;
    float hi8[8], ga[8], gl[8];
#pragma unroll
    for (int e = 0; e < 8; ++e) { hi8[e] = hin[c8 + e]; ga[e] = g_attn[c8 + e]; gl[e] = g_lru[c8 + e]; }
    const size_t rowbase = prompt ? ((size_t)b * SEQ + (size_t)c * CH) : ((size_t)MP + (size_t)(unit - NB * NCH) * CH);
#pragma unroll 2
    for (int i = 0; i < 8; ++i) {
        const size_t row = rowbase + 8 * w + i;
        const u32x4 hl = *(const u32x4*)(HL + row * LW + c8), pp = *(const u32x4*)(PP + row * LW + c8), yg = *(const u32x4*)(Z + row * NIN + YG_OFF + c8), ao = *(const u32x4*)(ATTO + row * AW + c8);
        float fh[8], fp[8], fy[8], fa[8]; unpack8(hl, fh); unpack8(pp, fp); unpack8(yg, fy); unpack8(ao, fa);
        float ssl = 0.f, ssa = 0.f;
#pragma unroll
        for (int e = 0; e < 8; ++e) { const float hv = fh[e] + fp[e] * hi8[e]; const float v = hv * gelu_tanh(fy[e]); fh[e] = v; ssl += v * v; ssa += fa[e] * fa[e]; }
        const float rl = 1.0f / sqrtf(wave_sum(ssl) * (1.0f / LW) + EPS), ra = 1.0f / sqrtf(wave_sum(ssa) * (1.0f / AW) + EPS);
#pragma unroll
        for (int e = 0; e < 8; ++e) { fh[e] = fh[e] * rl * gl[e]; fa[e] = fa[e] * ra * ga[e]; }
        *(u32x4*)(MIX + row * DM + c8) = pack8(fa); *(u32x4*)(MIX + row * DM + AW + c8) = pack8(fh);
    }
    __syncthreads();
}

typedef const __attribute__((address_space(4))) Args* KArgP;
#define KARG() ({ KArgP p_ = (KArgP)__builtin_amdgcn_kernarg_segment_ptr(); asm volatile("" : "+s"(p_)); p_; })
#define TID() ({ int t_ = (int)threadIdx.x; asm volatile("" : "+v"(t_)); t_; })
#define SGL(x) ({ auto s_ = (x); asm volatile("" : "+s"(s_)); s_; })

__global__ void __launch_bounds__(512, 2) mk_fwd(Args args_unused) {
    extern __shared__ __attribute__((aligned(16))) unsigned char lds_raw[];
    LAS unsigned char* lds = (LAS unsigned char*)lds_raw;
    volatile LAS unsigned* MISC = (volatile LAS unsigned*)(lds + 131072 + 320);
    { const int tid = threadIdx.x; for (int u = tid; u < (LDS_BYTES - 131072) / 4; u += 512) ((LAS unsigned*)(lds + 131072))[u] = 0u; }
    __syncthreads();
    XcdBarrier bar = xcd_barrier_post((unsigned*)(KARG()->ws + WS_CTL) + 1024, MISC + 8);
    cg::grid_group grid = cg::this_grid();
#define GRID_BAR() xcd_barrier(bar)
#define PHASE_VARS() KArgP A = KARG(); const int tid = TID(); const int lane = tid & 63, wave = __builtin_amdgcn_readfirstlane(tid >> 6); const int G = SGL((int)gridDim.x), bx = SGL((int)blockIdx.x); \
        const int gw = bx * 8 + wave, NGW = G * 8; unsigned char* ws = A->ws; float* X = A->out; (void)lane; (void)gw; (void)NGW; (void)X; (void)ws

    {
        PHASE_VARS();
        bf16_t* XN = (bf16_t*)(ws + WS_XN);
        LAS float* scr = (LAS float*)(lds + wave * 16384);
        constexpr int I_G = 16 * 88, I_D = 44 * 32, I_IN = 16 * 56, I_O = 16 * 32, I_GT = 32;
        constexpr int PER_LAYER = 6 * I_G + I_IN + I_O + I_GT;
        static_assert(I_G == I_D, "items");
        for (int it = gw; it < 2 * PER_LAYER; it += NGW) {
            const int l = it / PER_LAYER; int r = it % PER_LAYER;
            unsigned char* wb = ws + WS_W + (size_t)l * LAYER_W;
            if (r < I_G) { transpose_item(A->in[7] + (size_t)l * DM * DFF, DM, DFF, (bf16_t*)(wb + OFF_GU1), 1, scr, r, lane); continue; } r -= I_G;
            if (r < I_G) { transpose_item(A->in[8] + (size_t)l * DM * DFF, DM, DFF, (bf16_t*)(wb + OFF_GU1), 2, scr, r, lane); continue; } r -= I_G;
            if (r < I_D) { transpose_item(A->in[9] + (size_t)l * DM * DFF, DFF, DM, (bf16_t*)(wb + OFF_D1), 0, scr, r, lane); continue; } r -= I_D;
            if (r < I_G) { transpose_item(A->in[26] + (size_t)l * DM * DFF, DM, DFF, (bf16_t*)(wb + OFF_GU2), 1, scr, r, lane); continue; } r -= I_G;
            if (r < I_G) { transpose_item(A->in[27] + (size_t)l * DM * DFF, DM, DFF, (bf16_t*)(wb + OFF_GU2), 2, scr, r, lane); continue; } r -= I_G;
            if (r < I_D) { transpose_item(A->in[28] + (size_t)l * DM * DFF, DFF, DM, (bf16_t*)(wb + OFF_D2), 0, scr, r, lane); continue; } r -= I_D;
            if (r < I_IN) { transpose_item(A->in[12] + (size_t)l * DM * NIN, DM, NIN, (bf16_t*)(wb + OFF_IN), 0, scr, r, lane); continue; } r -= I_IN;
            if (r < I_O) { transpose_item(A->in[23] + (size_t)l * DM * DM, DM, DM, (bf16_t*)(wb + OFF_O), 0, scr, r, lane); continue; } r -= I_O;
            { const int gsel = r >> 4, hh = (r >> 1) & 7, item = r & 1;
              transpose_item(A->in[gsel ? 18 : 16] + (size_t)l * 32768 + hh * 4096, 64, 64, (bf16_t*)(wb + (gsel ? OFF_GX : OFF_GA)) + hh * 4096, 0, scr, item, lane); }
        }
        const float* g0 = A->in[6];
        const float* xp = A->in[0]; const float* xs = A->in[1];
        for (int m = gw; m < M; m += NGW) {
            const float* src = (m < MP) ? xp + (size_t)m * DM : xs + (size_t)(m - MP) * DM;
            const f32x4* xr = (const f32x4*)src + lane; f32x4 v[4]; float ss = 0.f;
#pragma unroll
            for (int j = 0; j < 4; ++j) { v[j] = xr[64 * j]; ss += (v[j][0] * v[j][0] + v[j][1] * v[j][1]) + (v[j][2] * v[j][2] + v[j][3] * v[j][3]); }
            const float rs = 1.0f / sqrtf(wave_sum(ss) * (1.0f / DM) + EPS);
            f32x4* xo = (f32x4*)(X + (size_t)m * DM) + lane; u32x2* o = (u32x2*)(XN + (size_t)m * DM) + lane;
#pragma unroll
            for (int j = 0; j < 4; ++j) { xo[64 * j] = v[j]; const f32x4 g = ((const f32x4*)g0)[lane + 64 * j]; const f32x4 t = v[j] * g * rs; u32x2 w; w.x = pk2(t[0], t[1]); w.y = pk2(t[2], t[3]); o[64 * j] = w; }
        }
    }
    grid.sync();

#pragma unroll 1
    for (int l = 0; l < 2; ++l) {
#pragma unroll 1
        for (int f = 0; f < 2; ++f) {
            if (f == 1) {
                { PHASE_VARS(); unsigned char* wb = ws + WS_W + (size_t)l * LAYER_W;
                  pg8::Gemm g{(const bf16_t*)(ws + WS_XN), (const bf16_t*)(wb + OFF_IN), M, NIN, DM}; pg8::StaticOrder S; S.init(M, NIN, G, bx); pg8::Epi<0> E{(bf16_t*)(ws + WS_Z), NIN}; pg8::gemm_phase(lds, g, S, E, tid); }
                GRID_BAR();
                { PHASE_VARS(); for (int u = bx; u < 256; u += G) attn_prompt_unit(lds, u, (const bf16_t*)(ws + WS_Z), (bf16_t*)(ws + WS_ATTO), A->in[13] + l * 8, X + O_KP + (size_t)l * 32768, X + O_VP + (size_t)l * 32768, tid); }
                { PHASE_VARS(); unsigned char* wb = ws + WS_W + (size_t)l * LAYER_W;
                  for (int u = bx; u < NB * NCH; u += G)
                        lru_prompt_unit(lds, u, (const bf16_t*)(ws + WS_Z), A->in[14] + l * 4 * LW, A->in[15] + l * LW, (const bf16_t*)(wb + OFF_GA), (const bf16_t*)(wb + OFF_GX), A->in[17] + l * LW, A->in[19] + l * LW,
                                        A->in[20] + l * LW, (bf16_t*)(ws + WS_HL), (bf16_t*)(ws + WS_PP), (float*)(ws + WS_SUM), X + O_CP + (size_t)l * 3072, tid); }
                { PHASE_VARS(); for (int u = bx; u < 2 * DB; u += G) attn_sample_unit(lds, u, l, (const bf16_t*)(ws + WS_Z), (bf16_t*)(ws + WS_ATTO), A->in[13] + l * 8, A->in[2], A->in[3], X + O_KS + (size_t)l * 2097152, X + O_VS + (size_t)l * 2097152, tid); }
                { PHASE_VARS(); for (int u = bx; u < DB; u += G)
                        lru_sample_unit(lds, u, (const bf16_t*)(ws + WS_Z), A->in[14] + l * 4 * LW, A->in[15] + l * LW, A->in[16] + (size_t)l * 32768, A->in[18] + (size_t)l * 32768, A->in[17] + l * LW, A->in[19] + l * LW,
                                        A->in[20] + l * LW, A->in[4] + (size_t)l * DB * 3 * LW, A->in[5] + (size_t)l * DB * LW, (bf16_t*)(ws + WS_HL), (bf16_t*)(ws + WS_PP), X + O_CS + (size_t)l * 196608, X + O_HS + (size_t)l * 65536, tid); }
                GRID_BAR();
                { PHASE_VARS(); for (int u = bx; u < NB * NCH + MS / CH; u += G)
                        mix_final_unit(lds, u, (const bf16_t*)(ws + WS_Z), (const bf16_t*)(ws + WS_ATTO), (const bf16_t*)(ws + WS_HL), (const bf16_t*)(ws + WS_PP), (const float*)(ws + WS_SUM), A->in[21] + l * AW, A->in[22] + l * LW,
                                       (bf16_t*)(ws + WS_MIX), X + O_HP + (size_t)l * 1024, tid); }
                GRID_BAR();
                { PHASE_VARS(); unsigned char* wb = ws + WS_W + (size_t)l * LAYER_W;
                  pg8::Gemm g{(const bf16_t*)(ws + WS_MIX), (const bf16_t*)(wb + OFF_O), M, DM, DM}; pg8::StaticOrder S; S.init(M, DM, G, bx); pg8::Epi<0> E{(bf16_t*)(ws + WS_Y), DM}; pg8::gemm_phase(lds, g, S, E, tid); }
                GRID_BAR();
                { PHASE_VARS(); elem_phase(X, (const bf16_t*)(ws + WS_Y), (bf16_t*)(ws + WS_XN), A->in[24] + l * DM, A->in[25] + l * DM, 1.0f, gw, NGW, lane); }
                GRID_BAR();
            }
            { PHASE_VARS(); unsigned char* wb = ws + WS_W + (size_t)l * LAYER_W;
              pg8::Gemm g{(const bf16_t*)(ws + WS_XN), (const bf16_t*)(wb + (f ? OFF_GU2 : OFF_GU1)), M, 2 * DFF, DM}; pg8::StaticOrder S; S.init(M, 2 * DFF, G, bx); pg8::Epi<1> E{(bf16_t*)(ws + WS_H), DFF}; pg8::gemm_phase(lds, g, S, E, tid); }
            GRID_BAR();
            { PHASE_VARS(); unsigned char* wb = ws + WS_W + (size_t)l * LAYER_W;
              pg8::Gemm g{(const bf16_t*)(ws + WS_H), (const bf16_t*)(wb + (f ? OFF_D2 : OFF_D1)), M, DM, DFF}; pg8::StaticOrder S; S.init(M, DM, G, bx); pg8::Epi<0> E{(bf16_t*)(ws + WS_Y), DM}; pg8::gemm_phase(lds, g, S, E, tid); }
            GRID_BAR();
            {
                PHASE_VARS();
                const float* gpost = (f ? A->in[29] : A->in[10]) + l * DM;
                const float* gpre = f ? (l == 0 ? A->in[6] + DM : nullptr) : A->in[11] + l * DM;
                elem_phase(X, (const bf16_t*)(ws + WS_Y), (bf16_t*)(ws + WS_XN), gpost, gpre, 0.5f, gw, NGW, lane);
            }
            if (!(l == 1 && f == 1)) GRID_BAR();
        }
    }
}

extern "C" void kernel_launch(void* const* d_in, const int* in_sizes, int n_in, void* d_out, int out_size, void* d_ws, size_t ws_size, hipStream_t stream) {
    static int grid = 0;
    if (grid == 0) {
        int dev = 0, cus = 0, per_cu = 0;
        hipGetDevice(&dev);
        hipDeviceGetAttribute(&cus, hipDeviceAttributeMultiprocessorCount, dev);
        hipFuncSetAttribute((const void*)mk_fwd, hipFuncAttributeMaxDynamicSharedMemorySize, LDS_BYTES);
        hipOccupancyMaxActiveBlocksPerMultiprocessor(&per_cu, (const void*)mk_fwd, 512, LDS_BYTES);
        (void)hipGetLastError();
        if (per_cu < 1) { fprintf(stderr, "occupancy query says %d blocks per CU\n", per_cu); per_cu = 1; }
        grid = cus * 1;
        if (ws_size < WS_END || n_in != 30) { fprintf(stderr, "kernel_launch: unexpected sizes (ws %zu, n_in %d)\n", ws_size, n_in); }
    }
    hipMemsetAsync((char*)d_ws + WS_CTL, 0, CTL_BYTES, stream);
    Args a{};
    for (int i = 0; i < 30; ++i) a.in[i] = (const float*)d_in[i];
    a.out = (float*)d_out; a.ws = (unsigned char*)d_ws;
    void* kargs[] = {&a};
    hipError_t e = hipLaunchCooperativeKernel((const void*)mk_fwd, dim3(grid), dim3(512), kargs, LDS_BYTES, stream);
    if (e != hipSuccess) fprintf(stderr, "cooperative launch failed: %s (grid %d)\n", hipGetErrorString(e), grid);
}
```
